# Optimizing an MI355X kernel written in HIP

```python
import math
import jax, jax.numpy as jnp
from jax import lax
import numpy as np

D_MODEL = 1024
BATCH = 8
SEQ = 4096
DEPTH = 1

CHUNK = 64
MIX_W = D_MODEL
FOX_W = MIX_W // 2
LRU_W = MIX_W - FOX_W
FOX_HEADS = 8
FOX_HD = FOX_W // FOX_HEADS
LRU_BLOCKS = 8
LRU_BW = LRU_W // LRU_BLOCKS
LRU_C = 8.0
CONV_K = 4
D_FF = 4 * D_MODEL
Q_BLOCK = 128
LN_EPS = 1e-5
DN_ALPHA = (2.0 * DEPTH) ** 0.25
DN_BETA = (8.0 * DEPTH) ** -0.25

Q_OFF = 0
K_OFF = Q_OFF + FOX_W
V_OFF = K_OFF + FOX_W
LX_OFF = V_OFF + FOX_W
LG_OFF = LX_OFF + LRU_W
FG_OFF = LG_OFF + LRU_W
IN_COLS = FG_OFF + FOX_HEADS

kernel_name = "fox_rglru_macaron_deepnorm_block"


def layer_norm(x, g, b):
    xf = x.astype(jnp.float32)
    mu = jnp.mean(xf, axis=-1, keepdims=True)
    var = jnp.mean(jnp.square(xf - mu), axis=-1, keepdims=True)
    y = (xf - mu) * lax.rsqrt(var + LN_EPS) * g.astype(jnp.float32) + b.astype(jnp.float32)
    return y.astype(x.dtype)


def swiglu(x, w_gate, w_up, w_down):
    return (jax.nn.silu(x @ w_gate) * (x @ w_up)) @ w_down


def forgetting_attention(q, k, v, fg_logit):
    seq = q.shape[1]
    scale = 1.0 / math.sqrt(FOX_HD)
    cum = jnp.cumsum(jax.nn.log_sigmoid(fg_logit.astype(jnp.float32)), axis=1)
    cum = cum.transpose(0, 2, 1)
    qh = q.transpose(0, 2, 1, 3)
    kh = k.transpose(0, 2, 1, 3)
    vh = v.transpose(0, 2, 1, 3)
    outs = []
    for i in range(seq // Q_BLOCK):
        q0, q1 = i * Q_BLOCK, (i + 1) * Q_BLOCK
        s = jnp.einsum('bhqd,bhkd->bhqk', qh[:, :, q0:q1], kh[:, :, :q1],
                       preferred_element_type=jnp.float32) * scale
        s = s + cum[:, :, q0:q1, None] - cum[:, :, None, :q1]
        mask = jnp.arange(q0, q1)[:, None] >= jnp.arange(q1)[None, :]
        s = jnp.where(mask, s, -1e30)
        p = jax.nn.softmax(s, axis=-1).astype(vh.dtype)
        outs.append(jnp.einsum('bhqk,bhkd->bqhd', p, vh[:, :, :q1]))
    return jnp.concatenate(outs, axis=1)


def causal_depthwise_conv(u, w, b):
    y = lax.conv_general_dilated(u, w[:, None, :], window_strides=(1,), padding=[(CONV_K - 1, 0)],
                                 dimension_numbers=('NWC', 'WIO', 'NWC'),
                                 feature_group_count=u.shape[-1])
    return y + b


def _lin_rec_combine(c1, c2):
    a1, b1 = c1
    a2, b2 = c2
    return a1 * a2, a2 * b1 + b2


def rg_lru(u, wa, ba, wx, bx, lam):
    bsz, seq, width = u.shape
    ub = u.reshape(bsz, seq, LRU_BLOCKS, LRU_BW)
    r = jax.nn.sigmoid(jnp.einsum('bshi,hij->bshj', ub, wa) + ba).reshape(bsz, seq, width)
    gi = jax.nn.sigmoid(jnp.einsum('bshi,hij->bshj', ub, wx) + bx).reshape(bsz, seq, width)
    log_a = -LRU_C * r.astype(jnp.float32) * jax.nn.softplus(-lam.astype(jnp.float32))
    a = jnp.exp(log_a)
    bterm = jnp.sqrt(-jnp.expm1(2.0 * log_a)) * (gi * u).astype(jnp.float32)
    _, h = lax.associative_scan(_lin_rec_combine, (a, bterm), axis=1)
    return h.astype(u.dtype)


def setup_inputs(seed: int = 0) -> dict:
    key = jax.random.key(seed)
    ks = iter(jax.random.split(key, 32))
    f32 = jnp.float32

    def nrm(shape, scale):
        return jax.random.normal(next(ks), shape, f32) * scale

    d_in, d_ff = D_MODEL ** -0.5, D_FF ** -0.5
    x = jax.random.normal(next(ks), (BATCH, SEQ, D_MODEL), f32)
    w_in = nrm((DEPTH, D_MODEL, IN_COLS), d_in)
    w_in = w_in.at[:, :, V_OFF:V_OFF + FOX_W].multiply(DN_BETA)
    a0 = jax.random.uniform(next(ks), (DEPTH, LRU_W), f32, 0.9, 0.999)
    p = a0 ** (1.0 / LRU_C)
    lru_lambda = jnp.log(p) - jnp.log1p(-p)
    return {
        "x": x,
        "ffn1_w_gate": nrm((DEPTH, D_MODEL, D_FF), d_in),
        "ffn1_w_up": nrm((DEPTH, D_MODEL, D_FF), d_in),
        "ffn1_w_down": nrm((DEPTH, D_FF, D_MODEL), d_ff * DN_BETA),
        "ln1_g": 1.0 + nrm((DEPTH, D_MODEL), 0.02),
        "ln1_b": nrm((DEPTH, D_MODEL), 0.02),
        "w_in": w_in,
        "b_forget": 3.0 + nrm((DEPTH, FOX_HEADS), 0.1),
        "conv_w": nrm((DEPTH, CONV_K, LRU_W), CONV_K ** -0.5),
        "conv_b": nrm((DEPTH, LRU_W), 0.02),
        "rg_wa": nrm((DEPTH, LRU_BLOCKS, LRU_BW, LRU_BW), LRU_BW ** -0.5),
        "rg_ba": nrm((DEPTH, LRU_BLOCKS, LRU_BW), 0.02),
        "rg_wx": nrm((DEPTH, LRU_BLOCKS, LRU_BW, LRU_BW), LRU_BW ** -0.5),
        "rg_bx": nrm((DEPTH, LRU_BLOCKS, LRU_BW), 0.02),
        "lru_lambda": lru_lambda,
        "w_out": nrm((DEPTH, MIX_W, D_MODEL), (MIX_W ** -0.5) * DN_BETA),
        "ln2_g": 1.0 + nrm((DEPTH, D_MODEL), 0.02),
        "ln2_b": nrm((DEPTH, D_MODEL), 0.02),
        "ffn2_w_gate": nrm((DEPTH, D_MODEL, D_FF), d_in),
        "ffn2_w_up": nrm((DEPTH, D_MODEL, D_FF), d_in),
        "ffn2_w_down": nrm((DEPTH, D_FF, D_MODEL), d_ff * DN_BETA),
        "ln3_g": 1.0 + nrm((DEPTH, D_MODEL), 0.02),
        "ln3_b": nrm((DEPTH, D_MODEL), 0.02),
    }


def reference(x, ffn1_w_gate, ffn1_w_up, ffn1_w_down, ln1_g, ln1_b, w_in, b_forget,
              conv_w, conv_b, rg_wa, rg_ba, rg_wx, rg_bx, lru_lambda, w_out,
              ln2_g, ln2_b, ffn2_w_gate, ffn2_w_up, ffn2_w_down, ln3_g, ln3_b):
    bsz, seq, _ = x.shape
    for l in range(DEPTH):
        x = layer_norm(DN_ALPHA * x + 0.5 * swiglu(x, ffn1_w_gate[l], ffn1_w_up[l], ffn1_w_down[l]),
                       ln1_g[l], ln1_b[l])
        z = x @ w_in[l]
        q = z[..., Q_OFF:Q_OFF + FOX_W].reshape(bsz, seq, FOX_HEADS, FOX_HD)
        k = z[..., K_OFF:K_OFF + FOX_W].reshape(bsz, seq, FOX_HEADS, FOX_HD)
        v = z[..., V_OFF:V_OFF + FOX_W].reshape(bsz, seq, FOX_HEADS, FOX_HD)
        fg = z[..., FG_OFF:FG_OFF + FOX_HEADS] + b_forget[l]
        fox = forgetting_attention(q, k, v, fg).reshape(bsz, seq, FOX_W)
        u = causal_depthwise_conv(z[..., LX_OFF:LX_OFF + LRU_W], conv_w[l], conv_b[l])
        rec = rg_lru(u, rg_wa[l], rg_ba[l], rg_wx[l], rg_bx[l], lru_lambda[l])
        lru = jax.nn.gelu(z[..., LG_OFF:LG_OFF + LRU_W]) * rec
        mix = jnp.concatenate([fox, lru], axis=-1) @ w_out[l]
        x = layer_norm(DN_ALPHA * x + mix, ln2_g[l], ln2_b[l])
        x = layer_norm(DN_ALPHA * x + 0.5 * swiglu(x, ffn2_w_gate[l], ffn2_w_up[l], ffn2_w_down[l]),
                       ln3_g[l], ln3_b[l])
    return x
```

```cpp
#include <hip/hip_runtime.h>
#include <cstdio>
#include <cstdint>
#include <cmath>

namespace nv {
constexpr int BATCH = 8, SEQ = 4096, DM = 1024, M = BATCH * SEQ, DFF = 4096;
constexpr int FOXW = 512, LRUW = 512, NH = 8, HD = 64, INC = 2568;
constexpr int Q_OFF = 0, K_OFF = 512, V_OFF = 1024, LX_OFF = 1536, LG_OFF = 2048, FG_OFF = 2560;
constexpr float ALPHA = 1.189207115002721f;
constexpr float LN_EPS = 1e-5f;

template <int MODE>
__global__ void __launch_bounds__(256) ngemm(const float* __restrict__ A, int lda, const float* __restrict__ B, int ldb,
                                             float* C, int ldc, int Mr, int N, int K) {
    __shared__ float As[16][132];
    __shared__ float Bs[16][132];
    const int tid = threadIdx.x, tx = tid & 15, ty = tid >> 4;
    const int m0 = blockIdx.y * 128, n0 = blockIdx.x * 128;
    float acc[8][8];
#pragma unroll
    for (int i = 0; i < 8; ++i)
#pragma unroll
        for (int j = 0; j < 8; ++j) acc[i][j] = 0.f;
    for (int k0 = 0; k0 < K; k0 += 16) {
#pragma unroll
        for (int i = 0; i < 2; ++i) {
            const int e = tid + i * 256;
            const int r = e >> 2, kq = (e & 3) * 4;
            const float4 v = *(const float4*)(A + (size_t)(m0 + r) * lda + k0 + kq);
            As[kq + 0][r] = v.x; As[kq + 1][r] = v.y; As[kq + 2][r] = v.z; As[kq + 3][r] = v.w;
        }
#pragma unroll
        for (int i = 0; i < 8; ++i) {
            const int e = tid + i * 256;
            const int kk = e >> 7, n = e & 127;
            Bs[kk][n] = (n0 + n < N) ? B[(size_t)(k0 + kk) * ldb + n0 + n] : 0.f;
        }
        __syncthreads();
#pragma unroll
        for (int kk = 0; kk < 16; ++kk) {
            float a[8], b[8];
            *(float4*)&a[0] = *(const float4*)&As[kk][ty * 8]; *(float4*)&a[4] = *(const float4*)&As[kk][ty * 8 + 4];
            *(float4*)&b[0] = *(const float4*)&Bs[kk][tx * 8]; *(float4*)&b[4] = *(const float4*)&Bs[kk][tx * 8 + 4];
#pragma unroll
            for (int i = 0; i < 8; ++i)
#pragma unroll
                for (int j = 0; j < 8; ++j) acc[i][j] = fmaf(a[i], b[j], acc[i][j]);
        }
        __syncthreads();
    }
#pragma unroll
    for (int i = 0; i < 8; ++i) {
        const int r = m0 + ty * 8 + i;
#pragma unroll
        for (int j = 0; j < 8; ++j) {
            const int c = n0 + tx * 8 + j;
            if (c < N) {
                float v = acc[i][j];
                if (MODE == 1) { const float g = C[(size_t)r * ldc + c]; v = (g / (1.f + expf(-g))) * v; }
                C[(size_t)r * ldc + c] = v;
            }
        }
    }
}

__device__ __forceinline__ float wsum(float v) {
#pragma unroll
    for (int o = 1; o < 64; o <<= 1) v += __shfl_xor(v, o);
    return v;
}
__global__ void __launch_bounds__(256) nln(const float* xin, const float* y, float s, const float* __restrict__ g, const float* __restrict__ b, float* out, int rows) {
    const int row = blockIdx.x * 4 + (threadIdx.x >> 6), lane = threadIdx.x & 63;
    if (row >= rows) return;
    float v[16]; float sum = 0.f;
#pragma unroll
    for (int j = 0; j < 4; ++j) {
        const float4 a = *(const float4*)(xin + (size_t)row * DM + j * 256 + lane * 4);
        const float4 c = *(const float4*)(y + (size_t)row * DM + j * 256 + lane * 4);
        v[j * 4 + 0] = ALPHA * a.x + s * c.x; v[j * 4 + 1] = ALPHA * a.y + s * c.y; v[j * 4 + 2] = ALPHA * a.z + s * c.z; v[j * 4 + 3] = ALPHA * a.w + s * c.w;
        sum += v[j * 4] + v[j * 4 + 1] + v[j * 4 + 2] + v[j * 4 + 3];
    }
    const float mean = wsum(sum) * (1.f / DM); float q = 0.f;
#pragma unroll
    for (int i = 0; i < 16; ++i) { v[i] -= mean; q += v[i] * v[i]; }
    const float rstd = 1.f / sqrtf(wsum(q) * (1.f / DM) + LN_EPS);
#pragma unroll
    for (int j = 0; j < 4; ++j) {
        const float4 gg = *(const float4*)(g + j * 256 + lane * 4), bb = *(const float4*)(b + j * 256 + lane * 4);
        float4 o; o.x = v[j * 4] * rstd * gg.x + bb.x; o.y = v[j * 4 + 1] * rstd * gg.y + bb.y; o.z = v[j * 4 + 2] * rstd * gg.z + bb.z; o.w = v[j * 4 + 3] * rstd * gg.w + bb.w;
        *(float4*)(out + (size_t)row * DM + j * 256 + lane * 4) = o;
    }
}

__global__ void ncum(const float* z, const float* bf, float* cum) {
    const int h = threadIdx.x; if (h >= NH) return;
    float c = 0.f; const float bb = bf[h];
    for (int t = 0; t < SEQ; ++t) {
        const float x = z[(size_t)t * INC + FG_OFF + h] + bb;
        const float ls = fminf(x, 0.f) - log1pf(expf(-fabsf(x)));
        c += ls; cum[t * NH + h] = c;
    }
}

__global__ void __launch_bounds__(64) nattn(const float* z, const float* cum, float* mix  ) {
    __shared__ float Ks[64][65];
    __shared__ float Vs[64][65];
    __shared__ float Cs[64];
    const int h = blockIdx.y, qb = blockIdx.x, tid = threadIdx.x, t = qb * 64 + tid;
    float q[64], o[64];
#pragma unroll
    for (int d = 0; d < 64; ++d) { q[d] = z[(size_t)t * INC + Q_OFF + h * HD + d] * 0.125f; o[d] = 0.f; }
    const float cq = cum[t * NH + h];
    float m = -1e30f, l = 0.f;
    for (int kb = 0; kb <= qb; ++kb) {
        __syncthreads();
        for (int e = tid; e < 64 * 64; e += 64) { const int r = e >> 6, d = e & 63;
            Ks[r][d] = z[(size_t)(kb * 64 + r) * INC + K_OFF + h * HD + d];
            Vs[r][d] = z[(size_t)(kb * 64 + r) * INC + V_OFF + h * HD + d]; }
        Cs[tid] = cum[(kb * 64 + tid) * NH + h];
        __syncthreads();
        const int nk = (kb == qb) ? tid + 1 : 64;
        for (int j = 0; j < nk; ++j) {
            float s = 0.f;
#pragma unroll
            for (int d = 0; d < 64; ++d) s = fmaf(q[d], Ks[j][d], s);
            s += cq - Cs[j];
            if (s > m) { const float f = expf(m - s); l *= f;
#pragma unroll
                for (int d = 0; d < 64; ++d) o[d] *= f;
                m = s; }
            const float p = expf(s - m); l += p;
#pragma unroll
            for (int d = 0; d < 64; ++d) o[d] = fmaf(p, Vs[j][d], o[d]);
        }
    }
    const float il = 1.f / l;
#pragma unroll
    for (int d = 0; d < 64; ++d) mix[(size_t)t * DM + h * HD + d] = o[d] * il;
}

__global__ void nconv(const float* z, const float* cw, const float* cb, float* u) {
    const int idx = blockIdx.x * blockDim.x + threadIdx.x; if (idx >= SEQ * LRUW) return;
    const int t = idx / LRUW, c = idx % LRUW;
    float acc = cb[c];
#pragma unroll
    for (int k = 0; k < 4; ++k) { const int tt = t - 3 + k; if (tt >= 0) acc = fmaf(cw[k * LRUW + c], z[(size_t)tt * INC + LX_OFF + c], acc); }
    u[idx] = acc;
}
__global__ void ngate(const float* u, const float* wa, const float* ba, const float* wx, const float* bx, const float* lam, float* a, float* bt) {
    const int idx = blockIdx.x * blockDim.x + threadIdx.x; if (idx >= SEQ * LRUW) return;
    const int t = idx / LRUW, c = idx % LRUW, blk = c >> 6, j = c & 63;
    float ra = ba[c], rx = bx[c];
    for (int i = 0; i < 64; ++i) { const float uu = u[t * LRUW + blk * 64 + i]; ra = fmaf(uu, wa[(blk * 64 + i) * 64 + j], ra); rx = fmaf(uu, wx[(blk * 64 + i) * 64 + j], rx); }
    const float r = 1.f / (1.f + expf(-ra)), gi = 1.f / (1.f + expf(-rx));
    const float lm = lam[c]; const float sp = fmaxf(-lm, 0.f) + log1pf(expf(-fabsf(lm)));
    const float log_a = -8.f * r * sp;
    a[idx] = expf(log_a); bt[idx] = sqrtf(-expm1f(2.f * log_a)) * (gi * u[idx]);
}
__global__ void nscan(const float* a, const float* bt, const float* z, float* mix) {
    const int c = blockIdx.x * blockDim.x + threadIdx.x; if (c >= LRUW) return;
    float h = 0.f;
    for (int t = 0; t < SEQ; ++t) {
        h = fmaf(a[t * LRUW + c], h, bt[t * LRUW + c]);
        const float x = z[(size_t)t * INC + LG_OFF + c];
        const float ge = 0.5f * x * (1.f + tanhf(0.7978845608028654f * (x + 0.044715f * x * x * x)));
        mix[(size_t)t * DM + FOXW + c] = ge * h;
    }
}
}

static void naive_forward(void* const* d_in, float* out, unsigned char* ws, hipStream_t stream) {
    using namespace nv;
    const float* x = (const float*)d_in[0];
    const float *wg1 = (const float*)d_in[1], *wu1 = (const float*)d_in[2], *wd1 = (const float*)d_in[3], *g1 = (const float*)d_in[4], *b1 = (const float*)d_in[5];
    const float *win = (const float*)d_in[6], *bfg = (const float*)d_in[7], *cw = (const float*)d_in[8], *cb = (const float*)d_in[9];
    const float *wa = (const float*)d_in[10], *ba = (const float*)d_in[11], *wx = (const float*)d_in[12], *bx = (const float*)d_in[13], *lam = (const float*)d_in[14];
    const float *wout = (const float*)d_in[15], *g2 = (const float*)d_in[16], *b2 = (const float*)d_in[17];
    const float *wg2 = (const float*)d_in[18], *wu2 = (const float*)d_in[19], *wd2 = (const float*)d_in[20], *g3 = (const float*)d_in[21], *b3 = (const float*)d_in[22];
    const size_t MB = 1u << 20;
    float* XA = (float*)(ws + 0);
    float* Y = (float*)(ws + 128 * MB);
    float* G = (float*)(ws + 256 * MB);
    float* Zb = (float*)(ws + 320 * MB);
    float* MIXb = (float*)(ws + 364 * MB);
    float* Ab = (float*)(ws + 380 * MB);
    float* Bb = (float*)(ws + 388 * MB);
    float* Ub = (float*)(ws + 396 * MB);
    float* CUMb = (float*)(ws + 404 * MB);
    const int CH = 4096;
    auto ffn = [&](const float* xin, const float* wg, const float* wu, const float* wd) {
        for (int c = 0; c < M / CH; ++c) {
            const float* xc = xin + (size_t)c * CH * DM;
            hipLaunchKernelGGL(ngemm<0>, dim3(DFF / 128, CH / 128), dim3(256), 0, stream, xc, DM, wg, DFF, G, DFF, CH, DFF, DM);
            hipLaunchKernelGGL(ngemm<1>, dim3(DFF / 128, CH / 128), dim3(256), 0, stream, xc, DM, wu, DFF, G, DFF, CH, DFF, DM);
            hipLaunchKernelGGL(ngemm<0>, dim3(DM / 128, CH / 128), dim3(256), 0, stream, (const float*)G, DFF, wd, DM, Y + (size_t)c * CH * DM, DM, CH, DM, DFF);
        }
    };
    ffn(x, wg1, wu1, wd1);
    hipLaunchKernelGGL(nln, dim3(M / 4), dim3(256), 0, stream, x, (const float*)Y, 0.5f, g1, b1, XA, M);
    for (int b = 0; b < BATCH; ++b) {
        const float* xb = XA + (size_t)b * SEQ * DM;
        hipLaunchKernelGGL(ngemm<0>, dim3((INC + 127) / 128, SEQ / 128), dim3(256), 0, stream, xb, DM, win, INC, Zb, INC, SEQ, INC, DM);
        hipLaunchKernelGGL(ncum, dim3(1), dim3(64), 0, stream, (const float*)Zb, bfg, CUMb);
        hipLaunchKernelGGL(nattn, dim3(SEQ / 64, NH), dim3(64), 0, stream, (const float*)Zb, (const float*)CUMb, MIXb);
        hipLaunchKernelGGL(nconv, dim3(SEQ * LRUW / 256), dim3(256), 0, stream, (const float*)Zb, cw, cb, Ub);
        hipLaunchKernelGGL(ngate, dim3(SEQ * LRUW / 256), dim3(256), 0, stream, (const float*)Ub, wa, ba, wx, bx, lam, Ab, Bb);
        hipLaunchKernelGGL(nscan, dim3(LRUW / 64), dim3(64), 0, stream, (const float*)Ab, (const float*)Bb, (const float*)Zb, MIXb);
        hipLaunchKernelGGL(ngemm<0>, dim3(DM / 128, SEQ / 128), dim3(256), 0, stream, (const float*)MIXb, DM, wout, DM, Y + (size_t)b * SEQ * DM, DM, SEQ, DM, DM);
    }
    hipLaunchKernelGGL(nln, dim3(M / 4), dim3(256), 0, stream, (const float*)XA, (const float*)Y, 1.0f, g2, b2, out, M);
    ffn(out, wg2, wu2, wd2);
    hipLaunchKernelGGL(nln, dim3(M / 4), dim3(256), 0, stream, (const float*)out, (const float*)Y, 0.5f, g3, b3, out, M);
}

extern "C" void kernel_launch(void* const* d_in, const int* in_sizes, int n_in, void* d_out, int out_size, void* d_ws, size_t ws_size, hipStream_t stream) {
    naive_forward(d_in, (float*)d_out, (unsigned char*)d_ws, stream);
}
```
